# Optimizing an MI355X kernel written in HIP

```python
import jax, jax.numpy as jnp
from jax import lax
import numpy as np

D_MODEL = 1024
BATCH = 8
SEQ = 2048
DEPTH = 4

N_GROUPS = 4
GROUP_WIDTH = D_MODEL // N_GROUPS
HEADS = 4
RWKV_HEAD = GROUP_WIDTH // HEADS
RWKV_DECAY_RANK = 32
RWKV_A_RANK = 32
RWKV_GATE_RANK = 64
RWKV_GN_EPS = 64e-5
GLA_KEY_WIDTH = GROUP_WIDTH // 2
GLA_HEAD_K = GLA_KEY_WIDTH // HEADS
GLA_HEAD_V = GROUP_WIDTH // HEADS
GLA_GATE_RANK = 16
GLA_GATE_TAU = 16.0
LRU_CONV = 4
LRU_BLOCK = GROUP_WIDTH // HEADS
LRU_C = 8.0
HGRN_HEAD = GROUP_WIDTH // HEADS
CHUNK = 32
FFN_HIDDEN = -(-8 * D_MODEL // (3 * 256)) * 256
NORM_EPS = 1e-6

RWKV_COLS = 3 * GROUP_WIDTH + RWKV_DECAY_RANK + RWKV_A_RANK + RWKV_GATE_RANK
GLA_COLS = 2 * GLA_KEY_WIDTH + GROUP_WIDTH + GLA_GATE_RANK + GROUP_WIDTH
LRU_COLS = 2 * GROUP_WIDTH
HGRN_COLS = 4 * GROUP_WIDTH
IN_COLS = RWKV_COLS + GLA_COLS + LRU_COLS + HGRN_COLS

kernel_name = 'hymba_style_rwkv7_gla_rglru_hgrn2_trunk'


def _split(t, sizes):
    idx, acc = [], 0
    for s in sizes[:-1]:
        acc += s
        idx.append(acc)
    return jnp.split(t, idx, axis=-1)


def _rms_norm(x, g):
    xf = x.astype(jnp.float32)
    y = xf * lax.rsqrt(jnp.mean(xf * xf, axis=-1, keepdims=True) + NORM_EPS)
    return (y * g.astype(jnp.float32)).astype(x.dtype)


def _heads(t, h):
    b, s, c = t.shape
    return t.reshape(b, s, h, c // h)


def _rwkv7_scan(r, w, k, v, kk, a):
    b, t, h, n = r.shape
    xs = tuple(jnp.moveaxis(z, 1, 0) for z in (r, w, k, v, kk, a))

    def step(S, inp):
        r_t, w_t, k_t, v_t, kk_t, a_t = inp
        sa = jnp.einsum('bhvk,bhk->bhv', S, -kk_t)
        S = (S * w_t[:, :, None, :] + sa[..., None] * (kk_t * a_t)[:, :, None, :]
             + v_t[..., None] * k_t[:, :, None, :])
        return S, jnp.einsum('bhvk,bhk->bhv', S, r_t)

    S0 = jnp.zeros((b, h, n, n), jnp.float32)
    _, y = lax.scan(step, S0, xs)
    return jnp.moveaxis(y, 0, 1)


def _rwkv7_group(p, mu, w0, w_up, a0, a_up, g_up, k_k, k_a, r_k, ln_w, ln_b):
    p = p.astype(jnp.float32)
    prev = jnp.pad(p, ((0, 0), (1, 0), (0, 0)))[:, :-1]
    u = p + (prev - p) * mu
    r, k, v, w_low, a_low, g_low = _split(u, (GROUP_WIDTH, GROUP_WIDTH, GROUP_WIDTH,
                                             RWKV_DECAY_RANK, RWKV_A_RANK, RWKV_GATE_RANK))
    w_log = -jax.nn.softplus(-(w0 + jnp.tanh(w_low) @ w_up)) - 0.5
    decay = jnp.exp(-jnp.exp(w_log))
    a = jax.nn.sigmoid(a0 + a_low @ a_up)
    g = jax.nn.sigmoid(g_low) @ g_up
    r, k, v, decay, a = (_heads(z, HEADS) for z in (r, k, v, decay, a))
    kk = _heads(_heads(k.reshape(k.shape[0], k.shape[1], -1), 1)[..., 0, :] * k_k, HEADS)
    kk = kk / jnp.maximum(jnp.sqrt(jnp.sum(kk * kk, axis=-1, keepdims=True)), 1e-12)
    k = k * (1.0 + (a - 1.0) * _heads(k_a[None, None, :], HEADS))
    y = _rwkv7_scan(r, decay, k, v, kk, a)
    mean = jnp.mean(y, axis=-1, keepdims=True)
    var = jnp.mean(jnp.square(y - mean), axis=-1, keepdims=True)
    y = ((y - mean) * lax.rsqrt(var + RWKV_GN_EPS) * ln_w.reshape(HEADS, RWKV_HEAD)
         + ln_b.reshape(HEADS, RWKV_HEAD))
    y = y + jnp.sum(r * k * r_k, axis=-1, keepdims=True) * v
    return y.reshape(p.shape[0], p.shape[1], GROUP_WIDTH) * g


def _chunked_gla(q, k, v, log_g):
    b, t, h, dk = q.shape
    dv = v.shape[-1]
    n = t // CHUNK

    def to_chunks(z):
        return z.reshape(b, n, CHUNK, h, z.shape[-1]).transpose(1, 0, 3, 2, 4)

    causal = jnp.tril(jnp.ones((CHUNK, CHUNK), dtype=bool))[:, :, None]

    def step(S, inp):
        q_c, k_c, v_c, g_c = inp
        cum = jnp.cumsum(g_c, axis=-2)
        inter = jnp.einsum('bhtk,bhkv->bhtv', q_c * jnp.exp(cum), S)
        diff = cum[:, :, :, None, :] - cum[:, :, None, :, :]
        decay = jnp.exp(jnp.where(causal, diff, -jnp.inf))
        att = jnp.einsum('bhtk,bhsk,bhtsk->bhts', q_c, k_c, decay)
        intra = jnp.einsum('bhts,bhsv->bhtv', att, v_c)
        last = cum[:, :, -1:, :]
        S = (jnp.exp(last[:, :, 0, :])[..., None] * S
             + jnp.einsum('bhsk,bhsv->bhkv', k_c * jnp.exp(last - cum), v_c))
        return S, inter + intra

    S0 = jnp.zeros((b, h, dk, dv), jnp.float32)
    _, o = lax.scan(step, S0, (to_chunks(q), to_chunks(k), to_chunks(v), to_chunks(log_g)))
    return o.transpose(1, 0, 3, 2, 4).reshape(b, t, h, dv)


def _gla_group(p, gate_up, gate_b, norm_w):
    p = p.astype(jnp.float32)
    q, k, v, a_low, g = _split(p, (GLA_KEY_WIDTH, GLA_KEY_WIDTH, GROUP_WIDTH, GLA_GATE_RANK, GROUP_WIDTH))
    log_alpha = jax.nn.log_sigmoid(a_low @ gate_up + gate_b) / GLA_GATE_TAU
    o = _chunked_gla(_heads(q * GLA_HEAD_K ** -0.5, HEADS), _heads(k, HEADS),
                     _heads(v, HEADS), _heads(log_alpha, HEADS))
    o = _rms_norm(o, norm_w).reshape(p.shape[0], p.shape[1], GROUP_WIDTH)
    return o * jax.nn.silu(g)


def _lru_combine(left, right):
    a_l, b_l = left
    a_r, b_r = right
    return a_l * a_r, a_r * b_l + b_r


def _rglru_group(p, conv_w, conv_b, w_a, b_a, w_x, b_x, lam):
    p = p.astype(jnp.float32)
    xb, gate = _split(p, (GROUP_WIDTH, GROUP_WIDTH))
    xc = lax.conv_general_dilated(xb, conv_w.astype(jnp.float32)[:, None, :], window_strides=(1,),
                                  padding=[(LRU_CONV - 1, 0)],
                                  dimension_numbers=('NWC', 'WIO', 'NWC'),
                                  feature_group_count=GROUP_WIDTH) + conv_b
    xh = _heads(xc, HEADS)
    bsz, t = xc.shape[0], xc.shape[1]
    r = jax.nn.sigmoid(jnp.einsum('bthi,hij->bthj', xh, w_a).reshape(bsz, t, GROUP_WIDTH) + b_a)
    i = jax.nn.sigmoid(jnp.einsum('bthi,hij->bthj', xh, w_x).reshape(bsz, t, GROUP_WIDTH) + b_x)
    log_a = -LRU_C * r * jax.nn.softplus(-lam)
    a = jnp.exp(log_a)
    mult = jnp.sqrt(jnp.maximum(-jnp.expm1(2.0 * log_a), 0.0))
    _, h = lax.associative_scan(_lru_combine, (a, mult * (i * xc)), axis=1)
    return h * jax.nn.gelu(gate)


def _hgrn2_group(p, lb, norm_w):
    p = p.astype(jnp.float32)
    q, f_logit, i, g = _split(p, (GROUP_WIDTH,) * 4)
    lb = lb.astype(jnp.float32)
    f = lb + (1.0 - lb) * jax.nn.sigmoid(f_logit)
    o = _chunked_gla(_heads(q, HEADS), _heads(1.0 - f, HEADS), _heads(i, HEADS),
                     _heads(jnp.log(f), HEADS))
    o = _rms_norm(o, norm_w).reshape(p.shape[0], p.shape[1], GROUP_WIDTH)
    return o * jax.nn.silu(g)


def setup_inputs(seed: int = 0) -> dict:
    key = jax.random.key(seed)
    ks = iter(jax.random.split(key, 40))
    f32 = jnp.float32
    L = DEPTH

    def nrm(shape, scale):
        return jax.random.normal(next(ks), shape, f32) * scale

    def gain(shape):
        return 1.0 + 0.05 * jax.random.normal(next(ks), shape, f32)

    def unif(shape, lo, hi):
        return jax.random.uniform(next(ks), shape, f32, lo, hi)

    u = unif((L, GROUP_WIDTH), 0.9, 0.999) ** (1.0 / LRU_C)
    lru_lambda = jnp.log(u) - jnp.log1p(-u)
    return {
        'x': jax.random.normal(next(ks), (BATCH, SEQ, D_MODEL), f32),
        'norm_mix_pre': gain((L, D_MODEL)),
        'norm_mix_post': gain((L, D_MODEL)),
        'norm_ffn_pre': gain((L, D_MODEL)),
        'norm_ffn_post': gain((L, D_MODEL)),
        'w_in': nrm((L, D_MODEL, IN_COLS), D_MODEL ** -0.5),
        'w_out': nrm((L, N_GROUPS * GROUP_WIDTH, D_MODEL), (N_GROUPS * GROUP_WIDTH) ** -0.5),
        'rwkv_shift_mu': unif((L, RWKV_COLS), 0.0, 1.0),
        'rwkv_w0': unif((L, GROUP_WIDTH), -6.0, 0.0),
        'rwkv_w_up': nrm((L, RWKV_DECAY_RANK, GROUP_WIDTH), 0.1),
        'rwkv_a0': unif((L, GROUP_WIDTH), -1.0, 1.0),
        'rwkv_a_up': nrm((L, RWKV_A_RANK, GROUP_WIDTH), 0.1),
        'rwkv_g_up': nrm((L, RWKV_GATE_RANK, GROUP_WIDTH), RWKV_GATE_RANK ** -0.5),
        'rwkv_k_k': 0.85 + 0.05 * jax.random.normal(next(ks), (L, GROUP_WIDTH), f32),
        'rwkv_k_a': gain((L, GROUP_WIDTH)),
        'rwkv_r_k': nrm((L, HEADS, RWKV_HEAD), 0.1),
        'rwkv_ln_w': gain((L, GROUP_WIDTH)),
        'rwkv_ln_b': nrm((L, GROUP_WIDTH), 0.01),
        'gla_gate_up': nrm((L, GLA_GATE_RANK, GLA_KEY_WIDTH), GLA_GATE_RANK ** -0.5),
        'gla_gate_b': nrm((L, GLA_KEY_WIDTH), 0.1),
        'gla_norm_w': gain((L, GLA_HEAD_V)),
        'lru_conv_w': nrm((L, LRU_CONV, GROUP_WIDTH), LRU_CONV ** -0.5),
        'lru_conv_b': nrm((L, GROUP_WIDTH), 0.01),
        'lru_w_a': nrm((L, HEADS, LRU_BLOCK, LRU_BLOCK), LRU_BLOCK ** -0.5),
        'lru_b_a': nrm((L, GROUP_WIDTH), 0.01),
        'lru_w_x': nrm((L, HEADS, LRU_BLOCK, LRU_BLOCK), LRU_BLOCK ** -0.5),
        'lru_b_x': nrm((L, GROUP_WIDTH), 0.01),
        'lru_lambda': lru_lambda,
        'hgrn_lb_logits': nrm((L, GROUP_WIDTH), 1.0),
        'hgrn_norm_w': gain((L, HGRN_HEAD)),
        'ffn_w_gate_up': nrm((L, D_MODEL, 2 * FFN_HIDDEN), D_MODEL ** -0.5),
        'ffn_w_down': nrm((L, FFN_HIDDEN, D_MODEL), FFN_HIDDEN ** -0.5),
    }


def reference(x, norm_mix_pre, norm_mix_post, norm_ffn_pre, norm_ffn_post, w_in, w_out,
              rwkv_shift_mu, rwkv_w0, rwkv_w_up, rwkv_a0, rwkv_a_up, rwkv_g_up, rwkv_k_k,
              rwkv_k_a, rwkv_r_k, rwkv_ln_w, rwkv_ln_b, gla_gate_up, gla_gate_b, gla_norm_w,
              lru_conv_w, lru_conv_b, lru_w_a, lru_b_a, lru_w_x, lru_b_x, lru_lambda,
              hgrn_lb_logits, hgrn_norm_w, ffn_w_gate_up, ffn_w_down):
    lb_p = jax.nn.softmax(hgrn_lb_logits.astype(jnp.float32), axis=0)
    lower_bounds = jnp.cumsum(lb_p, axis=0) - lb_p[0:1]
    for l in range(DEPTH):
        h = _rms_norm(x, norm_mix_pre[l])
        proj = h @ w_in[l]
        p_a, p_b, p_c, p_d = _split(proj, (RWKV_COLS, GLA_COLS, LRU_COLS, HGRN_COLS))
        y_a = _rwkv7_group(p_a, rwkv_shift_mu[l], rwkv_w0[l], rwkv_w_up[l], rwkv_a0[l],
                           rwkv_a_up[l], rwkv_g_up[l], rwkv_k_k[l], rwkv_k_a[l], rwkv_r_k[l],
                           rwkv_ln_w[l], rwkv_ln_b[l])
        y_b = _gla_group(p_b, gla_gate_up[l], gla_gate_b[l], gla_norm_w[l])
        y_c = _rglru_group(p_c, lru_conv_w[l], lru_conv_b[l], lru_w_a[l], lru_b_a[l],
                           lru_w_x[l], lru_b_x[l], lru_lambda[l])
        y_d = _hgrn2_group(p_d, lower_bounds[l], hgrn_norm_w[l])
        mixed = jnp.concatenate([y_a, y_b, y_c, y_d], axis=-1).astype(x.dtype) @ w_out[l]
        x = x + _rms_norm(mixed, norm_mix_post[l])
        h = _rms_norm(x, norm_ffn_pre[l])
        gate, up = jnp.split(h @ ffn_w_gate_up[l], 2, axis=-1)
        x = x + _rms_norm((jax.nn.silu(gate) * up) @ ffn_w_down[l], norm_ffn_post[l])
    return x
```

```cpp
#include <hip/hip_runtime.h>
#include <cstdio>
#include <cstdint>
namespace pg8 {
#define PG8_LAS __attribute__((address_space(3)))
typedef unsigned short bf16_t;
typedef short bf16x8 __attribute__((ext_vector_type(8)));
typedef float f32x4 __attribute__((ext_vector_type(4)));
typedef unsigned u32x4 __attribute__((ext_vector_type(4)));
constexpr int BM = 256, BK = 64, HALF = 128, HTB = HALF * BK * 2  , STAGE_BYTES = 8 * HTB, NXCD = 8, WGM = 8;

__host__ __device__ __forceinline__ int lds_byte(int r, int c) { const int st = (r >> 4) * 2 + (c >> 5), rr = r & 15, cc = c & 31, ob = rr * 64 + cc * 2; return st * 1024 + (ob ^ (((ob >> 9) & 1) << 5)); }
__host__ __device__ __forceinline__ void stage_rc(int b, int& R, int& C) { const int st = b / 1024, sb = b % 1024, swz = sb ^ (((sb >> 9) & 1) << 5); R = (st >> 1) * 16 + swz / 64; C = (st & 1) * 32 + (swz % 64) / 2; }
__host__ __device__ __forceinline__ int perm32(int rho) { const int n = rho >> 4, i = rho & 15; return 8 * (i >> 2) + 4 * n + (i & 3); }

struct Unit { int pm, pn; };
struct Gemm { const bf16_t* A; const bf16_t* Bt; int M, N, K; };

struct StaticOrder {
    int nM, nN, nwg, G, c;
    __host__ __device__ void init(int M, int N, int G_, int c_) { nM = M / BM; nN = N / BM; nwg = nM * nN; G = G_; c = c_; }
    __host__ __device__ bool next(int i, Unit& u) const {
        const long L = (long)i * G + c; if (L >= nwg) return false;
        int wgid = (int)L; { const int q = nwg / NXCD, r = nwg % NXCD, xcd = wgid % NXCD, off = wgid / NXCD; wgid = (xcd < r ? xcd * (q + 1) : r * (q + 1) + (xcd - r) * q) + off; }
        const int nig = WGM * nN, gid = wgid / nig, fm = gid * WGM, gsz = (nM - fm) < WGM ? (nM - fm) : WGM;
        u.pm = fm + ((wgid % nig) % gsz); u.pn = (wgid % nig) / gsz; return true;
    }
    __device__ __forceinline__ void a_ready(const Unit&) const {}
    __device__ __forceinline__ void done(const Unit&) const {}
};

__device__ __forceinline__ unsigned cvt_pk_bf16(float lo, float hi) { unsigned r; asm volatile("v_cvt_pk_bf16_f32 %0, %1, %2" : "=v"(r) : "v"(lo), "v"(hi)); return r; }
typedef float f32x2 __attribute__((ext_vector_type(2)));
__device__ __forceinline__ f32x2 gelu_pk(f32x2 v) {
    const f32x2 av = __builtin_elementwise_abs(v), d = av * 0.2316418882f + 1.0f;
    f32x2 t; t.x = __builtin_amdgcn_rcpf(d.x); t.y = __builtin_amdgcn_rcpf(d.y);
    f32x2 q = t * 0.5307027145f + (-0.7265760135f); q = q * t + 0.7107068705f; q = q * t + (-0.142248368f); q = q * t + 0.127414796f; q = q * t;
    const f32x2 s = (v * v) * (-0.72134752044f);
    f32x2 e; e.x = __builtin_amdgcn_exp2f(s.x); e.y = __builtin_amdgcn_exp2f(s.y);
    const f32x2 m = v * (q * e), r = v - m;
    f32x2 o; o.x = v.x < 0.f ? m.x : r.x; o.y = v.y < 0.f ? m.y : r.y; return o;
}

template <int ACT  > struct EpiBf16 {
    static constexpr bool PERM = true, AFTER_DRAIN = false; static_assert(ACT == 0 || ACT == 1, "EpiBf16: ACT is 0 (none) or 1 (gelu_pk)");
    bf16_t* O; int ldc; const float* bias; int split_cols; size_t split_stride; float scale0;
    __device__ __forceinline__ void operator()(const f32x4 (&acc)[2][2][4][2], const Unit& u, int wr, int wc, int fr, int fq) const {
        const int row0 = u.pm * BM + wr * 64 + fr; int colt = u.pn * BM; bf16_t* base = O;
        float sc = 1.f; if (split_cols) { const int t = colt / split_cols; base += (size_t)t * split_stride; colt -= t * split_cols; if (t == 0) sc = scale0; }
        const int col0 = colt + wc * 32 + 8 * fq, bcol0 = u.pn * BM + wc * 32 + 8 * fq;
        f32x4 bv[2][2];
#pragma unroll
        for (int bj = 0; bj < 2; ++bj)
#pragma unroll
            for (int n = 0; n < 2; ++n) bv[bj][n] = bias ? *(const f32x4*)(bias + bcol0 + bj * HALF + 4 * n) : (f32x4){0.f, 0.f, 0.f, 0.f};
#pragma unroll
        for (int ai = 0; ai < 2; ++ai)
#pragma unroll
            for (int m = 0; m < 4; ++m) { bf16_t* rowp = base + (size_t)(row0 + ai * HALF + m * 16) * ldc + col0;
#pragma unroll
                for (int bj = 0; bj < 2; ++bj) { f32x4 v0 = acc[ai][bj][m][0] + bv[bj][0], v1 = acc[ai][bj][m][1] + bv[bj][1];
                    if (ACT == 1) { f32x2 a = gelu_pk((f32x2){v0[0], v0[1]}), b = gelu_pk((f32x2){v0[2], v0[3]}), c = gelu_pk((f32x2){v1[0], v1[1]}), d = gelu_pk((f32x2){v1[2], v1[3]});
                        v0 = (f32x4){a.x, a.y, b.x, b.y}; v1 = (f32x4){c.x, c.y, d.x, d.y}; }
                    v0 = v0 * sc; v1 = v1 * sc; u32x4 w; w.x = cvt_pk_bf16(v0[0], v0[1]); w.y = cvt_pk_bf16(v0[2], v0[3]); w.z = cvt_pk_bf16(v1[0], v1[1]); w.w = cvt_pk_bf16(v1[2], v1[3]);
                    *(u32x4*)(rowp + bj * HALF) = w; } }
    }
};


struct EpiF32 {
    static constexpr bool PERM = false, AFTER_DRAIN = false;
    float* C; int ldc;
    __device__ __forceinline__ void operator()(const f32x4 (&acc)[2][2][4][2], const Unit& u, int wr, int wc, int fr, int fq) const {
        const int row0 = u.pm * BM + wr * 64 + fr, col0 = u.pn * BM + wc * 32 + 4 * fq;
#pragma unroll
        for (int ai = 0; ai < 2; ++ai)
#pragma unroll
            for (int m = 0; m < 4; ++m) { float* rowp = C + (size_t)(row0 + ai * HALF + m * 16) * ldc + col0;
#pragma unroll
                for (int bj = 0; bj < 2; ++bj)
#pragma unroll
                    for (int n = 0; n < 2; ++n) *(f32x4*)(rowp + bj * HALF + n * 16) = acc[ai][bj][m][n]; }
    }
};
typedef unsigned u32x2e __attribute__((ext_vector_type(2)));
struct EpiSwiglu {
    static constexpr bool PERM = true, AFTER_DRAIN = false;
    bf16_t* O; int ldo;
    __device__ __forceinline__ void operator()(const f32x4 (&acc)[2][2][4][2], const Unit& u, int wr, int wc, int fr, int fq) const {
        const int row0 = u.pm * BM + wr * 64 + fr, hcol0 = (u.pn * BM + wc * 32 + 8 * fq) >> 1;
#pragma unroll
        for (int ai = 0; ai < 2; ++ai)
#pragma unroll
            for (int m = 0; m < 4; ++m) { bf16_t* rowp = O + (size_t)(row0 + ai * HALF + m * 16) * ldo + hcol0;
#pragma unroll
                for (int bj = 0; bj < 2; ++bj) { const f32x4 g = acc[ai][bj][m][0], up = acc[ai][bj][m][1]; float hh[4];
#pragma unroll
                    for (int i = 0; i < 4; ++i) hh[i] = g[i] * __builtin_amdgcn_rcpf(1.0f + __expf(-g[i])) * up[i];
                    u32x2e w; w.x = cvt_pk_bf16(hh[0], hh[1]); w.y = cvt_pk_bf16(hh[2], hh[3]);
                    *(u32x2e*)(rowp + bj * (HALF / 2)) = w; } }
    }
};

struct PanelStats {
    unsigned* xbuf;
    unsigned* cnt;
    unsigned* tmo;
    int ntn; float eps;
    unsigned code;
    __device__ __forceinline__ bool run(const f32x4 (&v)[2][2][4][2], const Unit& u, int wr, int wc, int fr, int fq, PG8_LAS unsigned char* lds, int wid, int lane) const {
        typedef float f32x2v __attribute__((ext_vector_type(2)));
        PG8_LAS f32x2v* P = (PG8_LAS f32x2v*)lds;
        PG8_LAS f32x2v* S = (PG8_LAS f32x2v*)(lds + 8192);
        PG8_LAS unsigned* flag = (PG8_LAS unsigned*)(lds + 8192 + 2048);
#pragma unroll
        for (int ai = 0; ai < 2; ++ai)
#pragma unroll
            for (int m = 0; m < 4; ++m) {
                float s = 0.f;
#pragma unroll
                for (int bj = 0; bj < 2; ++bj)
#pragma unroll
                    for (int n = 0; n < 2; ++n) { const f32x4 x = v[ai][bj][m][n]; s += (x[0] + x[1]) + (x[2] + x[3]); }
                s += __shfl_xor(s, 16); s += __shfl_xor(s, 32);
                const float mw = s * (1.0f / 64.0f); float q = 0.f;
#pragma unroll
                for (int bj = 0; bj < 2; ++bj)
#pragma unroll
                    for (int n = 0; n < 2; ++n) { const f32x4 d = v[ai][bj][m][n] - mw; q += (d[0] * d[0] + d[1] * d[1]) + (d[2] * d[2] + d[3] * d[3]); }
                q += __shfl_xor(q, 16); q += __shfl_xor(q, 32);
                if (fq == 0) P[(ai * HALF + wr * 64 + m * 16 + fr) * 4 + wc] = (f32x2v){mw, q};
            }
        asm volatile("s_waitcnt lgkmcnt(0)" ::: "memory"); __builtin_amdgcn_s_barrier(); asm volatile("" ::: "memory");
#if defined(BROKEN_EXCHANGE_NO_WAIT)
#warning BROKEN CONTROL BUILD: the row-statistics exchange does not wait; results are wrong by design
        if (blockIdx.x >= 64) { const long long t0_ = clock64(); while (clock64() - t0_ < 60000) __builtin_amdgcn_s_sleep(8); }
#endif
        const int row = wid * 32 + (lane & 31);
        if (lane < 32) {
            const f32x2v a = P[row * 4 + 0], b = P[row * 4 + 1], c = P[row * 4 + 2], d = P[row * 4 + 3];
            const float mt = (a.x + b.x + c.x + d.x) * 0.25f;
            const float da = a.x - mt, db = b.x - mt, dc = c.x - mt, dd = d.x - mt;
            const float m2 = (a.y + b.y) + (c.y + d.y) + 64.0f * ((da * da + db * db) + (dc * dc + dd * dd));
            unsigned long long* slot = (unsigned long long*)xbuf + ((size_t)(u.pm * BM + row) * 4 + u.pn);
            __hip_atomic_store(slot, ((unsigned long long)__float_as_uint(m2) << 32) | __float_as_uint(mt), __ATOMIC_RELAXED, __HIP_MEMORY_SCOPE_AGENT);
        }
        asm volatile("s_waitcnt vmcnt(0)" ::: "memory");
        if (lane == 0) __hip_atomic_fetch_add(cnt + 64 * u.pm, 1u, __ATOMIC_RELAXED, __HIP_MEMORY_SCOPE_AGENT);
        if (wid == 0) {
            bool dead = false; const unsigned long long t0 = __builtin_amdgcn_s_memrealtime(); const unsigned want = 8u * (unsigned)ntn;
            for (;;) {
#if defined(BROKEN_EXCHANGE_NO_WAIT)
                break;
#endif
                if ((unsigned)__builtin_amdgcn_readfirstlane(__hip_atomic_load(cnt + 64 * u.pm, __ATOMIC_RELAXED, __HIP_MEMORY_SCOPE_AGENT)) >= want) break;
                if (__builtin_amdgcn_s_memrealtime() - t0 > 2000000ull) {
                    if (lane == 0) { unsigned expect = 0u; __hip_atomic_compare_exchange_strong(tmo + 1, &expect, code | (unsigned)(u.pm & 0xff), __ATOMIC_RELAXED, __ATOMIC_RELAXED, __HIP_MEMORY_SCOPE_AGENT);
                                     __hip_atomic_store(tmo, 1u, __ATOMIC_RELAXED, __HIP_MEMORY_SCOPE_AGENT); }
                    dead = true; break; }
                __builtin_amdgcn_s_sleep(2);
            }
            __builtin_amdgcn_fence(__ATOMIC_ACQUIRE, "agent");
            if (lane == 0) flag[0] = dead ? 1u : 0u;
        }
        asm volatile("s_waitcnt vmcnt(0) lgkmcnt(0)" ::: "memory"); __builtin_amdgcn_s_barrier(); asm volatile("" ::: "memory");
        const bool bad = flag[0] != 0u;
        if (lane < 32) {
            const unsigned long long* slot = (const unsigned long long*)xbuf + (size_t)(u.pm * BM + row) * 4; float mt[4], m2[4]; float ms = 0.f;
#pragma unroll
            for (int t = 0; t < 4; ++t) { if (t < ntn) { const unsigned long long w = __hip_atomic_load(slot + t, __ATOMIC_RELAXED, __HIP_MEMORY_SCOPE_AGENT); mt[t] = __uint_as_float((unsigned)w); m2[t] = __uint_as_float((unsigned)(w >> 32)); } else { mt[t] = 0.f; m2[t] = 0.f; } ms += mt[t]; }
            const float mean = ms / (float)ntn; float q = 0.f;
#pragma unroll
            for (int t = 0; t < 4; ++t) if (t < ntn) { const float dm = mt[t] - mean; q += m2[t] + 256.0f * dm * dm; }
            S[row] = (f32x2v){mean, 1.0f / sqrtf(q / (256.0f * (float)ntn) + eps)};
        }
        asm volatile("s_waitcnt lgkmcnt(0)" ::: "memory"); __builtin_amdgcn_s_barrier(); asm volatile("" ::: "memory");
        return bad;
    }
};
struct EpiLnRes {
    static constexpr bool PERM = false, AFTER_DRAIN = true;
    const float* base; float* out; int ldc; const float* bias; PanelStats st; unsigned poison;
    __device__ __forceinline__ void fused(f32x4 (&acc)[2][2][4][2], const Unit& u, int wr, int wc, int fr, int fq, PG8_LAS unsigned char* lds, int wid, int lane) const {
        typedef float f32x2v __attribute__((ext_vector_type(2)));
        const PG8_LAS f32x2v* S = (const PG8_LAS f32x2v*)(lds + 8192);
        const int col0 = u.pn * BM + wc * 32 + 4 * fq;
#pragma unroll
        for (int bj = 0; bj < 2; ++bj)
#pragma unroll
            for (int n = 0; n < 2; ++n) { const f32x4 bv = bias ? *(const f32x4*)(bias + col0 + bj * HALF + n * 16) : (f32x4){0.f, 0.f, 0.f, 0.f};
#pragma unroll
                for (int ai = 0; ai < 2; ++ai)
#pragma unroll
                    for (int m = 0; m < 4; ++m) acc[ai][bj][m][n] += bv; }
        f32x4 pre[4][2][2];
#pragma unroll
        for (int m = 0; m < 4; ++m) { const size_t off = (size_t)(u.pm * BM + wr * 64 + m * 16 + fr) * ldc + col0;
#pragma unroll
            for (int bj = 0; bj < 2; ++bj)
#pragma unroll
                for (int n = 0; n < 2; ++n) pre[m][bj][n] = *(const f32x4*)(base + off + bj * HALF + n * 16); }
        const bool bad = st.run(acc, u, wr, wc, fr, fq, lds, wid, lane) || poison != 0u;
        const float qnan = __builtin_nanf("");
#pragma unroll
        for (int ai = 0; ai < 2; ++ai)
#pragma unroll
            for (int m = 0; m < 4; ++m) { const int r = ai * HALF + wr * 64 + m * 16 + fr; const f32x2v sr = S[r]; const size_t off = (size_t)(u.pm * BM + r) * ldc + col0;
#pragma unroll
                for (int bj = 0; bj < 2; ++bj)
#pragma unroll
                    for (int n = 0; n < 2; ++n) { const f32x4 bs = ai == 0 ? pre[m][bj][n] : *(const f32x4*)(base + off + bj * HALF + n * 16); f32x4 o = bs + (acc[ai][bj][m][n] - sr.x) * sr.y;
                        if (bad) o = (f32x4){qnan, qnan, qnan, qnan}; *(f32x4*)(out + off + bj * HALF + n * 16) = o; }
                if (m & 1) asm volatile("" ::: "memory"); }
    }
};
struct EpiLnResLn {
    static constexpr bool PERM = false, AFTER_DRAIN = true;
    const float* base; float* out; bf16_t* xn; int ldc; const float* bias; PanelStats st1, st2; unsigned poison;
    __device__ __forceinline__ void fused(f32x4 (&acc)[2][2][4][2], const Unit& u, int wr, int wc, int fr, int fq, PG8_LAS unsigned char* lds, int wid, int lane) const {
        typedef float f32x2v __attribute__((ext_vector_type(2))); typedef unsigned u32x2v __attribute__((ext_vector_type(2)));
        const PG8_LAS f32x2v* S = (const PG8_LAS f32x2v*)(lds + 8192);
        const int col0 = u.pn * BM + wc * 32 + 4 * fq;
#pragma unroll
        for (int bj = 0; bj < 2; ++bj)
#pragma unroll
            for (int n = 0; n < 2; ++n) { const f32x4 bv = bias ? *(const f32x4*)(bias + col0 + bj * HALF + n * 16) : (f32x4){0.f, 0.f, 0.f, 0.f};
#pragma unroll
                for (int ai = 0; ai < 2; ++ai)
#pragma unroll
                    for (int m = 0; m < 4; ++m) acc[ai][bj][m][n] += bv; }
        bool bad = st1.run(acc, u, wr, wc, fr, fq, lds, wid, lane) || poison != 0u;
        const float qnan = __builtin_nanf("");
#pragma unroll
        for (int ai = 0; ai < 2; ++ai)
#pragma unroll
            for (int m = 0; m < 4; ++m) { const int r = ai * HALF + wr * 64 + m * 16 + fr; const f32x2v sr = S[r]; const size_t off = (size_t)(u.pm * BM + r) * ldc + col0;
#pragma unroll
                for (int bj = 0; bj < 2; ++bj)
#pragma unroll
                    for (int n = 0; n < 2; ++n) { const f32x4 bs = *(const f32x4*)(base + off + bj * HALF + n * 16); acc[ai][bj][m][n] = bs + (acc[ai][bj][m][n] - sr.x) * sr.y; }
                asm volatile("" : "+v"(acc[ai][0][m][0]), "+v"(acc[ai][0][m][1]), "+v"(acc[ai][1][m][0]), "+v"(acc[ai][1][m][1]));
                if (m & 1) asm volatile("" ::: "memory"); }
        const bool bad1 = bad;
        bad = st2.run(acc, u, wr, wc, fr, fq, lds, wid, lane) || bad;
#pragma unroll
        for (int ai = 0; ai < 2; ++ai)
#pragma unroll
            for (int m = 0; m < 4; ++m) { const int r = ai * HALF + wr * 64 + m * 16 + fr; const f32x2v sr = S[r]; const size_t off = (size_t)(u.pm * BM + r) * ldc + col0;
#pragma unroll
                for (int bj = 0; bj < 2; ++bj)
#pragma unroll
                    for (int n = 0; n < 2; ++n) { const f32x4 x1 = acc[ai][bj][m][n]; *(f32x4*)(out + off + bj * HALF + n * 16) = bad1 ? (f32x4){qnan, qnan, qnan, qnan} : x1;
                        const f32x4 o = (x1 - sr.x) * sr.y; u32x2v w; w.x = cvt_pk_bf16(o[0], o[1]); w.y = cvt_pk_bf16(o[2], o[3]);
                        if (bad) { w.x = 0x7fc07fc0u; w.y = 0x7fc07fc0u; } *(u32x2v*)(xn + off + bj * HALF + n * 16) = w; }
                asm volatile("" ::: "memory"); }
    }
};

template <class Epi, class Sched, bool ALIGN_EPI = false, bool SP2 = false>
__device__ __forceinline__ void gemm_phase(PG8_LAS unsigned char* lds, const Gemm g, const Sched& S, const Epi& E) {
    int tid_ = threadIdx.x; asm volatile("" : "+v"(tid_));
    const int tid = tid_, wid = __builtin_amdgcn_readfirstlane(tid >> 6), lane = tid & 63, wr = wid >> 2, wc = wid & 3, fr = lane & 15, fq = lane >> 4;
    const int K = g.K, nt = K / BK;
    unsigned voffA[2], voffB[2];
#pragma unroll
    for (int i = 0; i < 2; ++i) { int R, C; stage_rc(tid * 16 + i * 8192, R, C); const int Rb = Epi::PERM ? ((R & ~31) + perm32(R & 31)) : R;
        voffA[i] = (unsigned)(R * K + C) * 2u; voffB[i] = (unsigned)(Rb * K + C) * 2u; }
    const size_t kstep = (size_t)(BK * 2);
    const size_t hstep = (size_t)HALF * K * 2;
    const size_t tstep = 2 * hstep;
    const unsigned ldsw = (unsigned)wid * 1024u;
    const int aoff = lds_byte(wr * 64 + fr, fq * 8), boff = lds_byte(wc * 32 + fr, fq * 8);
#define PG8_SA(b, h) (((b) * 2 + (h)) * HTB)
#define PG8_SB(b, h) ((4 + (b) * 2 + (h)) * HTB)
#define PG8_STAGE(bufoff, gbase, voff) do { _Pragma("unroll") for (int _i = 0; _i < 2; ++_i) \
        __builtin_amdgcn_global_load_lds((const unsigned*)((const char*)(gbase) + (voff)[_i]), (PG8_LAS unsigned*)(lds + (bufoff) + ldsw + _i * 8192), 16, 0, 0); } while (0)
#define PG8_LDA(dst, b, h) do { _Pragma("unroll") for (int m = 0; m < 4; ++m) _Pragma("unroll") for (int k = 0; k < 2; ++k) dst[m][k] = *(const PG8_LAS bf16x8*)(lds + PG8_SA(b, h) + aoff + m * 2048 + k * 1024); } while (0)
#define PG8_LDB(dst, b, h) do { _Pragma("unroll") for (int n = 0; n < 2; ++n) _Pragma("unroll") for (int k = 0; k < 2; ++k) dst[n][k] = *(const PG8_LAS bf16x8*)(lds + PG8_SB(b, h) + boff + n * 2048 + k * 1024); } while (0)
#define PG8_MMA(ai, bj, At, Bt) do { __builtin_amdgcn_s_setprio(1); _Pragma("unroll") for (int m = 0; m < 4; ++m) _Pragma("unroll") for (int n = 0; n < 2; ++n) _Pragma("unroll") for (int k = 0; k < 2; ++k) \
        acc[ai][bj][m][n] = __builtin_amdgcn_mfma_f32_16x16x32_bf16(Bt[n][k], At[m][k], acc[ai][bj][m][n], 0, 0, 0); __builtin_amdgcn_s_setprio(0); } while (0)
#define PG8_WAIT_V(n) asm volatile("s_waitcnt vmcnt(" #n ")" ::: "memory")
#define PG8_WAIT_L(n) asm volatile("s_waitcnt lgkmcnt(" #n ")" ::: "memory")
#define PG8_BAR __builtin_amdgcn_s_barrier()
#define PG8_SCHED __builtin_amdgcn_sched_barrier(0)
    Unit cur, nxt; int ui = 0;
    if (!S.next(0, cur)) return;
    f32x4 acc[2][2][4][2];
#pragma unroll
    for (int a = 0; a < 2; ++a)
#pragma unroll
        for (int b = 0; b < 2; ++b)
#pragma unroll
            for (int m = 0; m < 4; ++m)
#pragma unroll
                for (int n = 0; n < 2; ++n) acc[a][b][m][n] = (f32x4){0.f, 0.f, 0.f, 0.f};
    bf16x8 At[4][2], B0[2][2], B1[2][2];
    const char* cA = (const char*)g.A + (size_t)cur.pm * tstep; const char* cB = (const char*)g.Bt + (size_t)cur.pn * tstep;
    S.a_ready(cur);
    if constexpr (SP2) {
        PG8_STAGE(PG8_SB(0, 0), cB, voffB); PG8_STAGE(PG8_SB(0, 1), cB + hstep, voffB); PG8_STAGE(PG8_SA(0, 0), cA, voffA); PG8_STAGE(PG8_SA(0, 1), cA + hstep, voffA);
        if (wr == 1) PG8_BAR;
        PG8_WAIT_V(2); PG8_BAR;
        PG8_STAGE(PG8_SB(1, 0), cB + kstep, voffB); PG8_STAGE(PG8_SA(1, 0), cA + kstep, voffA); PG8_STAGE(PG8_SB(1, 1), cB + hstep + kstep, voffB);
        PG8_WAIT_V(6); PG8_BAR;
    } else {
        PG8_STAGE(PG8_SB(0, 0), cB, voffB); PG8_STAGE(PG8_SA(0, 0), cA, voffA); PG8_STAGE(PG8_SB(0, 1), cB + hstep, voffB); PG8_STAGE(PG8_SA(0, 1), cA + hstep, voffA);
        if (wr == 1) PG8_BAR;
        PG8_WAIT_V(4); PG8_BAR;
        PG8_STAGE(PG8_SB(1, 0), cB + kstep, voffB); PG8_STAGE(PG8_SA(1, 0), cA + kstep, voffA); PG8_STAGE(PG8_SB(1, 1), cB + hstep + kstep, voffB);
        PG8_WAIT_V(6); PG8_BAR;
    }
    for (;;) {
        const bool has_next = S.next(ui + 1, nxt);
        const char* nA = has_next ? (const char*)g.A + (size_t)nxt.pm * tstep : cA; const char* nB = has_next ? (const char*)g.Bt + (size_t)nxt.pn * tstep : cB;
        for (int t = 0; t < nt; t += 2) {
            const bool last = (t == nt - 2);
            const char* a1 = cA + (size_t)(t + 1) * kstep;
            const char* a2 = last ? nA : cA + (size_t)(t + 2) * kstep; const char* b2 = last ? nB : cB + (size_t)(t + 2) * kstep;
            const char* a3 = a2 + kstep; const char* b3 = b2 + kstep;
            if (last && has_next) S.a_ready(nxt);
            if constexpr (SP2) {
            PG8_LDB(B0, 0, 0); PG8_LDB(B1, 0, 1); PG8_SCHED; PG8_LDA(At, 0, 0); PG8_STAGE(PG8_SA(1, 1), a1 + hstep, voffA);
            PG8_WAIT_V(8); PG8_WAIT_L(0); PG8_BAR; PG8_MMA(0, 0, At, B0); PG8_MMA(0, 1, At, B1); PG8_BAR; PG8_SCHED;
            PG8_LDA(At, 0, 1); PG8_STAGE(PG8_SB(0, 0), b2, voffB); PG8_STAGE(PG8_SB(0, 1), b2 + hstep, voffB); PG8_STAGE(PG8_SA(0, 0), a2, voffA);
            PG8_WAIT_V(8); PG8_WAIT_L(0); PG8_BAR; PG8_MMA(1, 0, At, B0); PG8_MMA(1, 1, At, B1); PG8_BAR; PG8_SCHED;
            PG8_LDB(B0, 1, 0); PG8_LDB(B1, 1, 1); PG8_SCHED; PG8_LDA(At, 1, 0); PG8_STAGE(PG8_SA(0, 1), a2 + hstep, voffA);
            PG8_WAIT_V(8); PG8_WAIT_L(0); PG8_BAR; PG8_MMA(0, 0, At, B0); PG8_MMA(0, 1, At, B1); PG8_BAR; PG8_SCHED;
            PG8_LDA(At, 1, 1); PG8_STAGE(PG8_SB(1, 0), b3, voffB); PG8_STAGE(PG8_SB(1, 1), b3 + hstep, voffB); PG8_STAGE(PG8_SA(1, 0), a3, voffA);
            PG8_WAIT_V(8); PG8_WAIT_L(0); PG8_BAR; PG8_MMA(1, 0, At, B0); PG8_MMA(1, 1, At, B1); PG8_BAR; PG8_SCHED;
            } else {
            PG8_LDB(B0, 0, 0); PG8_SCHED; PG8_LDA(At, 0, 0); PG8_STAGE(PG8_SA(1, 1), a1 + hstep, voffA);
            PG8_WAIT_L(8); PG8_BAR; PG8_WAIT_L(0); PG8_MMA(0, 0, At, B0); PG8_BAR; PG8_SCHED;
            PG8_LDB(B1, 0, 1); PG8_STAGE(PG8_SB(0, 0), b2, voffB);
            PG8_BAR; PG8_WAIT_L(0); PG8_MMA(0, 1, At, B1); PG8_BAR;
            PG8_LDA(At, 0, 1); PG8_STAGE(PG8_SA(0, 0), a2, voffA);
            PG8_BAR; PG8_WAIT_L(0); PG8_MMA(1, 0, At, B0); PG8_BAR; PG8_SCHED;
            PG8_STAGE(PG8_SB(0, 1), b2 + hstep, voffB);
            PG8_WAIT_V(6); PG8_BAR; PG8_MMA(1, 1, At, B1); PG8_BAR;
            PG8_LDB(B0, 1, 0); PG8_SCHED; PG8_LDA(At, 1, 0); PG8_STAGE(PG8_SA(0, 1), a2 + hstep, voffA);
            PG8_WAIT_L(8); PG8_BAR; PG8_WAIT_L(0); PG8_MMA(0, 0, At, B0); PG8_BAR; PG8_SCHED;
            PG8_LDB(B1, 1, 1); PG8_STAGE(PG8_SB(1, 0), b3, voffB);
            PG8_BAR; PG8_WAIT_L(0); PG8_MMA(0, 1, At, B1); PG8_BAR;
            PG8_LDA(At, 1, 1); PG8_STAGE(PG8_SA(1, 0), a3, voffA);
            PG8_BAR; PG8_WAIT_L(0); PG8_MMA(1, 0, At, B0); PG8_BAR; PG8_SCHED;
            PG8_STAGE(PG8_SB(1, 1), b3 + hstep, voffB);
            PG8_WAIT_V(6); PG8_BAR; PG8_MMA(1, 1, At, B1); PG8_BAR;
            }
        }
        if constexpr (ALIGN_EPI) { if (wr == 0) PG8_BAR; }
        if constexpr (!Epi::AFTER_DRAIN) { E(acc, cur, wr, wc, fr, fq); S.done(cur); }
        if (!has_next) break;
#pragma unroll
        for (int a = 0; a < 2; ++a)
#pragma unroll
            for (int b = 0; b < 2; ++b)
#pragma unroll
                for (int m = 0; m < 4; ++m)
#pragma unroll
                    for (int n = 0; n < 2; ++n) acc[a][b][m][n] = (f32x4){0.f, 0.f, 0.f, 0.f};
        cur = nxt; cA = nA; cB = nB; ++ui;
        if constexpr (ALIGN_EPI) { if (wr == 1) PG8_BAR; }
    }
    PG8_WAIT_V(0);
    if constexpr (!ALIGN_EPI) { if (wr == 0) PG8_BAR; }
    PG8_BAR;
    if constexpr (Epi::AFTER_DRAIN) { E.fused(acc, cur, wr, wc, fr, fq, lds, wid, lane); S.done(cur); }
#undef PG8_SA
#undef PG8_SB
#undef PG8_STAGE
#undef PG8_LDA
#undef PG8_LDB
#undef PG8_MMA
#undef PG8_WAIT_V
#undef PG8_WAIT_L
#undef PG8_BAR
#undef PG8_SCHED
}
}

constexpr int NWAVES = 8;
#ifndef MK_ONE_LAUNCH
#define MK_ONE_LAUNCH 0
#endif

constexpr int BATCH = 8, T = 2048, D = 1024, L = 4, FF = 2816;
constexpr int M = BATCH * T;
constexpr int NIN = 3216, NINP = 3328;
constexpr int NGU = 2 * FF;
constexpr int C_RWKV = 0, C_GLA = 896, C_LRU = 1680, C_HGRN = 2192;
constexpr float NORM_EPS = 1e-6f;

constexpr size_t MiB = 1u << 20;
constexpr size_t WS_CTL = 0, CTL_ZERO_BYTES = 1 * MiB;
constexpr size_t WS_WIN = 2 * MiB;
constexpr size_t WS_WOUT = 28 * MiB;
constexpr size_t WS_WGU = 36 * MiB;
constexpr size_t WS_WDN = 80 * MiB;
constexpr size_t WS_XCH = 102 * MiB;
constexpr size_t WS_XN = 104 * MiB;
constexpr size_t WS_Y = 136 * MiB;
constexpr size_t WS_TMP = 168 * MiB;
constexpr size_t WS_PROJ = 232 * MiB;
constexpr size_t WS_ACT = WS_PROJ;
constexpr size_t WS_END = 336 * MiB;
constexpr size_t SZ_WIN = (size_t)NINP * D * 2, SZ_WOUT = (size_t)D * D * 2, SZ_WGU = (size_t)NGU * D * 2, SZ_WDN = (size_t)D * FF * 2;
static_assert(WS_WIN + 4 * SZ_WIN <= WS_WOUT && WS_WOUT + 4 * SZ_WOUT <= WS_WGU && WS_WGU + 4 * SZ_WGU <= WS_WDN && WS_WDN + 4 * SZ_WDN <= WS_XCH, "weights map");
static_assert(WS_XN + (size_t)M * D * 2 <= WS_Y && WS_Y + (size_t)M * D * 2 <= WS_TMP && WS_TMP + (size_t)M * D * 4 <= WS_PROJ && WS_PROJ + (size_t)M * NINP * 2 <= WS_END, "activation map");
constexpr int CW_TMO = 0, CW_CODE = 1;
constexpr int CW_BAR = 4096;
constexpr int CW_SEAM = 16384, SEAM_BANK = 128 * 64;

constexpr int RING_OFF = 0, RING_BYTES = 131072;
constexpr int LDS_BYTES = 147456;
constexpr int LDSCTL_OFF = LDS_BYTES - 512;

#define GAS __attribute__((address_space(1)))
#define LAS __attribute__((address_space(3)))
typedef unsigned short bf16;
typedef unsigned v4u __attribute__((ext_vector_type(4)));
typedef float f32x4 __attribute__((ext_vector_type(4)));
typedef GAS unsigned gu32;
#define RLX_AGENT __ATOMIC_RELAXED, __HIP_MEMORY_SCOPE_AGENT
#define LDS_WAIT() asm volatile("s_waitcnt lgkmcnt(0)" ::: "memory")
#define VM_WAIT() asm volatile("s_waitcnt vmcnt(0)" ::: "memory")
__device__ __forceinline__ unsigned f2bf(float f) { unsigned u = __builtin_bit_cast(unsigned, f); return (u + 0x7fffu + ((u >> 16) & 1u)) >> 16; }
__device__ __forceinline__ unsigned pk2(float lo, float hi) { return f2bf(lo) | (f2bf(hi) << 16); }
__device__ __forceinline__ float bf2f(bf16 v) { return __builtin_bit_cast(float, ((unsigned)v) << 16); }
__device__ __forceinline__ float sigmoidf_(float x) { return 1.0f / (1.0f + __expf(-x)); }
__device__ __forceinline__ float softplusf_(float x) { return fmaxf(x, 0.f) + log1pf(__expf(-fabsf(x))); }

#define XB_TMO      128
#define XB_XCNT(j)  (256  + 64 * (j))
#define XB_XSUB(j)  (1280 + 64 * (j))
#define XB_XGEN(j)  (2304 + 64 * (j))
#define XB_TOP      3328
#define XB_TOPGEN   3392
#define XCD_BAR_WORDS 3456
#define XB_SPIN_CAP (1u << 18)
__device__ __forceinline__ unsigned xb_ld(unsigned* p)              { return __hip_atomic_load(p, __ATOMIC_RELAXED, __HIP_MEMORY_SCOPE_AGENT); }
__device__ __forceinline__ unsigned xb_add(unsigned* p, unsigned v) { return __hip_atomic_fetch_add(p, v, __ATOMIC_RELAXED, __HIP_MEMORY_SCOPE_AGENT); }
__device__ __forceinline__ unsigned xb_xcc_id() { return (unsigned)__builtin_amdgcn_s_getreg((3 << 11) | 20) & 0xFu; }
#define XB_SPIN(cond, bar) do { unsigned _sp = 0; while (cond) { __builtin_amdgcn_s_sleep(1); \
    if ((++_sp & 255u) == 0u) { if (xb_ld(&(bar)[XB_TMO])) break; if (_sp > XB_SPIN_CAP) { atomicAdd(&(bar)[XB_TMO], 1u); break; } } } } while (0)
struct XcdBarrier { unsigned* bar; unsigned x; volatile LAS unsigned* st; };
__device__ __forceinline__ XcdBarrier xcd_barrier_post(unsigned* bar, volatile LAS unsigned* st) {
    XcdBarrier b; b.bar = bar; b.x = xb_xcc_id(); b.st = st;
    if (threadIdx.x == 0) (void)xb_add(&bar[XB_XCNT(b.x)], 1u);
    return b;
}
__device__ __forceinline__ void xcd_barrier_complete(unsigned* bar, unsigned x, unsigned& nloc, unsigned& nx) {
    const unsigned G = gridDim.x * gridDim.y * gridDim.z;
    unsigned sum, cnt, mine, sp = 0u;
    for (;;) {
        sum = 0u; cnt = 0u; mine = 0u;
#pragma unroll
        for (unsigned j = 0; j < 16; ++j) { const unsigned c = xb_ld(&bar[XB_XCNT(j)]); sum += c; cnt += (c > 0u) ? 1u : 0u; mine = (j == x) ? c : mine; }
        if (sum == G) break;
        __builtin_amdgcn_s_sleep(1);
        if ((++sp & 255u) == 0u) { if (xb_ld(&bar[XB_TMO])) break; if (sp > XB_SPIN_CAP) { atomicAdd(&bar[XB_TMO], 1u); break; } }
    }
    nloc = mine > 0u ? mine : 1u; nx = cnt > 0u ? cnt : 1u;
}
__device__ __forceinline__ void xcd_barrier(const XcdBarrier& b) {
    asm volatile("s_waitcnt vmcnt(0)" ::: "memory");
    __syncthreads();
    if (threadIdx.x == 0) {
        unsigned* bar = b.bar;
        __builtin_amdgcn_s_waitcnt(0);
        unsigned nloc = b.st[0], nx = b.st[1];
        if (nloc == 0u) { xcd_barrier_complete(bar, b.x, nloc, nx); b.st[0] = nloc; b.st[1] = nx; }
        const unsigned old = xb_add(&bar[XB_XSUB(b.x)], 1u);
        const unsigned gen = old / nloc;
        if (old + 1u == (gen + 1u) * nloc) {
            __builtin_amdgcn_fence(__ATOMIC_RELEASE, "agent");
            asm volatile("s_waitcnt vmcnt(0)" ::: "memory");
            const unsigned og = xb_add(&bar[XB_TOP], 1u);
            const unsigned tg = og / nx;
            if (og + 1u == (tg + 1u) * nx) xb_add(&bar[XB_TOPGEN], 1u);
            else XB_SPIN(xb_ld(&bar[XB_TOPGEN]) == tg, bar);
            __builtin_amdgcn_fence(__ATOMIC_ACQUIRE, "agent");
            xb_add(&bar[XB_XGEN(b.x)], 1u);
            asm volatile("s_waitcnt vmcnt(0)" ::: "memory");
        } else {
            XB_SPIN(xb_ld(&bar[XB_XGEN(b.x)]) == gen, bar);
            __builtin_amdgcn_fence(__ATOMIC_ACQUIRE, "agent");
            asm volatile("s_waitcnt vmcnt(0)" ::: "memory");
        }
    }
    __syncthreads();
}

struct Args { const float* in[32]; float* out; unsigned char* ws; int ph_lo, ph_hi; };
struct Frame {
    LAS unsigned char* lds;
    volatile LAS unsigned* MISC;
    gu32* ctl;
    int tid, lane, wave;
    int vcu, G;
    const float* const* in;
    float* out; unsigned char* ws;
};
enum { I_X = 0, I_NMPRE, I_NMPOST, I_NFPRE, I_NFPOST, I_WIN, I_WOUT, I_MU, I_W0, I_WUP, I_A0, I_AUP, I_GUP, I_KK, I_KA, I_RK, I_LNW, I_LNB,
       I_GGU, I_GGB, I_GNW, I_CW, I_CB, I_LWA, I_LBA, I_LWX, I_LBX, I_LAM, I_HLB, I_HNW, I_WGU, I_WDN };

__device__ __forceinline__ float wave_sum(float v) {
#pragma unroll
    for (int o = 1; o < 64; o <<= 1) v += __shfl_xor(v, o);
    return v;
}
__device__ __forceinline__ float red16(float v) { v += __shfl_xor(v, 1); v += __shfl_xor(v, 2); v += __shfl_xor(v, 4); v += __shfl_xor(v, 8); return v; }
__device__ __forceinline__ float red8(float v) { v += __shfl_xor(v, 1); v += __shfl_xor(v, 2); v += __shfl_xor(v, 4); return v; }

template <int MODE>
__device__ __forceinline__ void p0_transpose_item(const float* W, int K, int Nin, int Nout, bf16* WT, LAS float* scr, int item, int lane) {
    const int nblk = Nout / 32, kb = item / nblk, nb = item % nblk, k0 = 64 * kb, n0 = 32 * nb;
    const int nl = n0 + (lane & 31);
#pragma unroll 8
    for (int i = 0; i < 32; ++i) { const int kk = 2 * i + (lane >> 5); scr[kk * 33 + (lane & 31)] = (nl < Nin) ? W[(size_t)(k0 + kk) * Nin + nl] : 0.f; }
    LDS_WAIT(); asm volatile("" ::: "memory");
    const int c = lane & 7;
#pragma unroll
    for (int j = 0; j < 4; ++j) { const int nn = (lane >> 3) + 8 * j; const LAS float* s = scr + (8 * c) * 33 + nn;
        v4u o; o.x = pk2(s[0 * 33], s[1 * 33]); o.y = pk2(s[2 * 33], s[3 * 33]); o.z = pk2(s[4 * 33], s[5 * 33]); o.w = pk2(s[6 * 33], s[7 * 33]);
        int n = n0 + nn, row = n;
        if (MODE == 1) { const int up = n >= FF ? 1 : 0, jj = n - up * FF; row = 8 * (jj >> 2) + 4 * up + (jj & 3); }
        *(GAS v4u*)(WT + (size_t)row * K + k0 + 8 * c) = o; }
    LDS_WAIT(); asm volatile("" ::: "memory");
}
__device__ __forceinline__ void rms_row_to_bf16(int lane, const float* xrow, const float* g, bf16* orow) {
    const GAS f32x4* xr = (const GAS f32x4*)xrow + lane; const GAS f32x4* gr = (const GAS f32x4*)g + lane;
    f32x4 v[4]; float s = 0.f;
#pragma unroll
    for (int j = 0; j < 4; ++j) { v[j] = xr[64 * j]; s += (v[j].x * v[j].x + v[j].y * v[j].y) + (v[j].z * v[j].z + v[j].w * v[j].w); }
    const float rs = 1.f / sqrtf(wave_sum(s) * (1.f / D) + NORM_EPS);
    GAS unsigned long long* o8 = (GAS unsigned long long*)orow + lane;
#pragma unroll
    for (int j = 0; j < 4; ++j) { const f32x4 gg = gr[64 * j]; o8[64 * j] = (unsigned long long)pk2(v[j].x * rs * gg.x, v[j].y * rs * gg.y) | ((unsigned long long)pk2(v[j].z * rs * gg.z, v[j].w * rs * gg.w) << 32); }
}
__device__ __forceinline__ void p0_prologue(Frame& F) {
    LAS float* scr = (LAS float*)(F.lds + RING_OFF + F.wave * 16384);
    const int gw = F.vcu * NWAVES + F.wave, NGW = F.G * NWAVES;
    constexpr int I_1 = (D / 64) * (NINP / 32), I_2 = (D / 64) * (D / 32), I_3 = (D / 64) * (NGU / 32), I_4 = (FF / 64) * (D / 32);
    constexpr int PER_L = I_1 + I_2 + I_3 + I_4;
    for (int it = gw; it < L * PER_L; it += NGW) {
        const int l = it / PER_L; int r = it % PER_L;
        if (r < I_1) { p0_transpose_item<0>(F.in[I_WIN] + (size_t)l * D * NIN, D, NIN, NINP, (bf16*)(F.ws + WS_WIN + l * SZ_WIN), scr, r, F.lane); continue; } r -= I_1;
        if (r < I_2) { p0_transpose_item<0>(F.in[I_WOUT] + (size_t)l * D * D, D, D, D, (bf16*)(F.ws + WS_WOUT + l * SZ_WOUT), scr, r, F.lane); continue; } r -= I_2;
        if (r < I_3) { p0_transpose_item<1>(F.in[I_WGU] + (size_t)l * D * NGU, D, NGU, NGU, (bf16*)(F.ws + WS_WGU + l * SZ_WGU), scr, r, F.lane); continue; } r -= I_3;
        p0_transpose_item<0>(F.in[I_WDN] + (size_t)l * FF * D, FF, D, D, (bf16*)(F.ws + WS_WDN + l * SZ_WDN), scr, r, F.lane);
    }
    bf16* XN = (bf16*)(F.ws + WS_XN);
    for (int m = gw; m < M; m += NGW) rms_row_to_bf16(F.lane, F.in[I_X] + (size_t)m * D, F.in[I_NMPRE], XN + (size_t)m * D);
}

__device__ __forceinline__ void norm_phase(Frame& F, const float* xold, const float* g1, const float* g2) {
    const int gw = F.vcu * NWAVES + F.wave, NGW = F.G * NWAVES;
    const float* tmp = (const float*)(F.ws + WS_TMP); bf16* XN = (bf16*)(F.ws + WS_XN);
    for (int m = gw; m < M; m += NGW) {
        const GAS f32x4* tr = (const GAS f32x4*)(tmp + (size_t)m * D) + F.lane; const GAS f32x4* xr = (const GAS f32x4*)(xold + (size_t)m * D) + F.lane;
        GAS f32x4* orow = (GAS f32x4*)(F.out + (size_t)m * D) + F.lane;
        f32x4 v[4]; float s = 0.f;
#pragma unroll
        for (int j = 0; j < 4; ++j) { v[j] = tr[64 * j]; s += (v[j].x * v[j].x + v[j].y * v[j].y) + (v[j].z * v[j].z + v[j].w * v[j].w); }
        const float rs = 1.f / sqrtf(wave_sum(s) * (1.f / D) + NORM_EPS);
        float s2 = 0.f;
#pragma unroll
        for (int j = 0; j < 4; ++j) { const f32x4 gg = ((const GAS f32x4*)g1 + F.lane)[64 * j]; const f32x4 xo = xr[64 * j]; v[j] = xo + v[j] * rs * gg; orow[64 * j] = v[j];
            s2 += (v[j].x * v[j].x + v[j].y * v[j].y) + (v[j].z * v[j].z + v[j].w * v[j].w); }
        if (g2) {
            const float rs2 = 1.f / sqrtf(wave_sum(s2) * (1.f / D) + NORM_EPS);
            GAS unsigned long long* o8 = (GAS unsigned long long*)(XN + (size_t)m * D) + F.lane;
#pragma unroll
            for (int j = 0; j < 4; ++j) { const f32x4 gg = ((const GAS f32x4*)g2 + F.lane)[64 * j];
                o8[64 * j] = (unsigned long long)pk2(v[j].x * rs2 * gg.x, v[j].y * rs2 * gg.y) | ((unsigned long long)pk2(v[j].z * rs2 * gg.z, v[j].w * rs2 * gg.w) << 32); }
        }
    }
}

constexpr int TT = 32;
constexpr int MX_VW = 0, MX_VA = 8192, MX_VB = 16384, MX_VK = 24576, MX_VQ = 32768, MX_VV = 40960, MX_YO = 49152, MX_G = 57344, MX_BON = 65536;
constexpr int MX_U = 65792;
constexpr int MX_W = 106752;
static_assert(MX_W + 32768 <= LDSCTL_OFF, "mixer LDS map");

template <bool HAS_AB>
__device__ __forceinline__ void recur_tile(float (&s)[8], LAS unsigned char* lds, int row, int ks, int nsteps) {
    const LAS float* Vw = (const LAS float*)(lds + MX_VW) + ks * 8; const LAS float* Va = (const LAS float*)(lds + MX_VA) + ks * 8; const LAS float* Vb = (const LAS float*)(lds + MX_VB) + ks * 8;
    const LAS float* Vk = (const LAS float*)(lds + MX_VK) + ks * 8; const LAS float* Vq = (const LAS float*)(lds + MX_VQ) + ks * 8; const LAS float* Vv = (const LAS float*)(lds + MX_VV) + row;
    LAS float* Yo = (LAS float*)(lds + MX_YO) + row;
    for (int st = 0; st < nsteps; ++st) {
        const f32x4 w0 = *(const LAS f32x4*)(Vw + st * 64), w1 = *(const LAS f32x4*)(Vw + st * 64 + 4);
        const f32x4 k0 = *(const LAS f32x4*)(Vk + st * 64), k1 = *(const LAS f32x4*)(Vk + st * 64 + 4);
        const f32x4 q0 = *(const LAS f32x4*)(Vq + st * 64), q1 = *(const LAS f32x4*)(Vq + st * 64 + 4);
        const float v = Vv[st * 64];
        const float w[8] = {w0.x, w0.y, w0.z, w0.w, w1.x, w1.y, w1.z, w1.w};
        const float k[8] = {k0.x, k0.y, k0.z, k0.w, k1.x, k1.y, k1.z, k1.w};
        const float q[8] = {q0.x, q0.y, q0.z, q0.w, q1.x, q1.y, q1.z, q1.w};
        if (HAS_AB) {
            const f32x4 a0 = *(const LAS f32x4*)(Va + st * 64), a1 = *(const LAS f32x4*)(Va + st * 64 + 4);
            const f32x4 b0 = *(const LAS f32x4*)(Vb + st * 64), b1 = *(const LAS f32x4*)(Vb + st * 64 + 4);
            const float a[8] = {a0.x, a0.y, a0.z, a0.w, a1.x, a1.y, a1.z, a1.w};
            const float b[8] = {b0.x, b0.y, b0.z, b0.w, b1.x, b1.y, b1.z, b1.w};
            float sa = 0.f;
#pragma unroll
            for (int i = 0; i < 8; ++i) sa += s[i] * a[i];
            sa = red8(sa);
#pragma unroll
            for (int i = 0; i < 8; ++i) s[i] = s[i] * w[i] + (sa * b[i] + v * k[i]);
        } else {
#pragma unroll
            for (int i = 0; i < 8; ++i) s[i] = s[i] * w[i] + v * k[i];
        }
        float y = 0.f;
#pragma unroll
        for (int i = 0; i < 8; ++i) y += s[i] * q[i];
        y = red8(y);
        if (ks == 0) Yo[st * 64] = y;
    }
}

__device__ __forceinline__ void rwkv_unit(Frame& F, int l, int b, int h) {
    LAS unsigned char* lds = F.lds; const int tid = F.tid;
    LAS float* Vw = (LAS float*)(lds + MX_VW); LAS float* Va = (LAS float*)(lds + MX_VA); LAS float* Vb = (LAS float*)(lds + MX_VB); LAS float* Vk = (LAS float*)(lds + MX_VK);
    LAS float* Vq = (LAS float*)(lds + MX_VQ); LAS float* Vv = (LAS float*)(lds + MX_VV); LAS float* Yo = (LAS float*)(lds + MX_YO); LAS float* Gg = (LAS float*)(lds + MX_G);
    LAS float* Bon = (LAS float*)(lds + MX_BON); LAS float* U = (LAS float*)(lds + MX_U);
    LAS float* Wl = (LAS float*)(lds + MX_W); LAS float* Al = Wl + 32 * 64; LAS float* Gl = Al + 32 * 64;
    const float* w_up = F.in[I_WUP] + (size_t)l * 32 * 256; const float* a_up = F.in[I_AUP] + (size_t)l * 32 * 256; const float* g_up = F.in[I_GUP] + (size_t)l * 64 * 256;
    for (int i = tid; i < 32 * 64; i += 512) { const int r = i >> 6, j = i & 63; Wl[i] = w_up[r * 256 + h * 64 + j]; Al[i] = a_up[r * 256 + h * 64 + j]; }
    for (int i = tid; i < 64 * 64; i += 512) { const int r = i >> 6, j = i & 63; Gl[i] = g_up[r * 256 + h * 64 + j]; }
    const float* mu = F.in[I_MU] + (size_t)l * 896;
    const int tok = tid >> 4, jb = tid & 15;
    float w0c[4], a0c[4], kkc[4], kac[4], rkc[4], lnw[4], lnb[4];
#pragma unroll
    for (int q = 0; q < 4; ++q) { const int c = h * 64 + jb + 16 * q; w0c[q] = F.in[I_W0][l * 256 + c]; a0c[q] = F.in[I_A0][l * 256 + c]; kkc[q] = F.in[I_KK][l * 256 + c]; kac[q] = F.in[I_KA][l * 256 + c];
        rkc[q] = F.in[I_RK][l * 256 + c]; lnw[q] = F.in[I_LNW][l * 256 + c]; lnb[q] = F.in[I_LNB][l * 256 + c]; }
    const bf16* proj = (const bf16*)(F.ws + WS_PROJ); bf16* Y = (bf16*)(F.ws + WS_Y);
    float s[8];
#pragma unroll
    for (int i = 0; i < 8; ++i) s[i] = 0.f;
    __syncthreads();
    for (int tile = 0; tile < T / TT; ++tile) {
        const int t0 = tile * TT; const size_t m0 = (size_t)b * T + t0;
        for (int e = tid; e < TT * 320; e += 512) { const int tk = e / 320, c = e - tk * 320; int col;
            if (c < 64) col = h * 64 + c; else if (c < 128) col = 256 + h * 64 + (c - 64); else if (c < 192) col = 512 + h * 64 + (c - 128); else col = 768 + (c - 192);
            const float p = bf2f(proj[(m0 + tk) * NINP + C_RWKV + col]); const float pp = (t0 + tk > 0) ? bf2f(proj[(m0 + tk - 1) * NINP + C_RWKV + col]) : 0.f;
            float u = p + (pp - p) * mu[col];
            if (c >= 192 && c < 224) u = tanhf(u); else if (c >= 256) u = sigmoidf_(u);
            U[e] = u; }
        __syncthreads();
        { const LAS float* Ut = U + tok * 320; float kk[4], av[4]; float nrm2 = 0.f, bon = 0.f;
          float wl[4], al[4], gg[4];
#pragma unroll
          for (int q = 0; q < 4; ++q) { wl[q] = w0c[q]; al[q] = a0c[q]; gg[q] = 0.f; }
#pragma unroll 2
          for (int i = 0; i < 32; ++i) { const float uw = Ut[192 + i], ua = Ut[224 + i];
#pragma unroll
            for (int q = 0; q < 4; ++q) { wl[q] += uw * Wl[i * 64 + jb + 16 * q]; al[q] += ua * Al[i * 64 + jb + 16 * q]; } }
#pragma unroll 2
          for (int i = 0; i < 64; ++i) { const float ug = Ut[256 + i];
#pragma unroll
            for (int q = 0; q < 4; ++q) gg[q] += ug * Gl[i * 64 + jb + 16 * q]; }
#pragma unroll
          for (int q = 0; q < 4; ++q) { const int j = jb + 16 * q;
            const float decay = __expf(-__expf(-softplusf_(-wl[q]) - 0.5f)); const float a = sigmoidf_(al[q]);
            const float r = Ut[j], k = Ut[64 + j], v = Ut[128 + j];
            kk[q] = k * kkc[q]; av[q] = a; const float kt = k * (1.f + (a - 1.f) * kac[q]);
            nrm2 += kk[q] * kk[q]; bon += r * kt * rkc[q];
            Vw[tok * 64 + j] = decay; Vk[tok * 64 + j] = kt; Vq[tok * 64 + j] = r; Vv[tok * 64 + j] = v; Gg[tok * 64 + j] = gg[q]; }
          nrm2 = red16(nrm2); bon = red16(bon);
          const float inv = 1.f / fmaxf(sqrtf(nrm2), 1e-12f);
#pragma unroll
          for (int q = 0; q < 4; ++q) { const int j = jb + 16 * q; const float kn = kk[q] * inv; Va[tok * 64 + j] = -kn; Vb[tok * 64 + j] = kn * av[q]; }
          if (jb == 0) Bon[tok] = bon; }
        __syncthreads();
        recur_tile<true>(s, lds, tid >> 3, tid & 7, TT);
        __syncthreads();
        { float y[4]; float sm = 0.f;
#pragma unroll
          for (int q = 0; q < 4; ++q) { y[q] = Yo[tok * 64 + jb + 16 * q]; sm += y[q]; }
          const float mean = red16(sm) * (1.f / 64.f); float sv = 0.f;
#pragma unroll
          for (int q = 0; q < 4; ++q) { const float d = y[q] - mean; sv += d * d; }
          const float rs = 1.f / sqrtf(red16(sv) * (1.f / 64.f) + 64e-5f); const float bn = Bon[tok];
#pragma unroll
          for (int q = 0; q < 4; ++q) { const int j = jb + 16 * q; const float o = ((y[q] - mean) * rs * lnw[q] + lnb[q] + bn * Vv[tok * 64 + j]) * Gg[tok * 64 + j];
            Y[(m0 + tok) * D + h * 64 + j] = (bf16)f2bf(o); } }
        __syncthreads();
    }
}

__device__ __forceinline__ void gla_unit(Frame& F, int l, int b, int h, int which) {
    LAS unsigned char* lds = F.lds; const int tid = F.tid;
    LAS float* Vw = (LAS float*)(lds + MX_VW); LAS float* Vk = (LAS float*)(lds + MX_VK); LAS float* Vq = (LAS float*)(lds + MX_VQ); LAS float* Vv = (LAS float*)(lds + MX_VV);
    LAS float* Yo = (LAS float*)(lds + MX_YO); LAS float* Gg = (LAS float*)(lds + MX_G); LAS float* U = (LAS float*)(lds + MX_U); LAS float* Wl = (LAS float*)(lds + MX_W);
    const bf16* proj = (const bf16*)(F.ws + WS_PROJ); bf16* Y = (bf16*)(F.ws + WS_Y);
    const int tok = tid >> 4, jb = tid & 15;
    float nw[4], lbc[4], gbc[4];
#pragma unroll
    for (int q = 0; q < 4; ++q) { const int j = jb + 16 * q; nw[q] = which ? F.in[I_HNW][l * 64 + j] : F.in[I_GNW][l * 64 + j]; lbc[q] = 0.f; gbc[q] = 0.f;
        if (which) { const int c = h * 64 + j; float z[4], mx = -1e30f;
#pragma unroll
            for (int i = 0; i < 4; ++i) { z[i] = F.in[I_HLB][i * 256 + c]; mx = fmaxf(mx, z[i]); }
            float den = 0.f, num = 0.f;
#pragma unroll
            for (int i = 0; i < 4; ++i) { const float e = __expf(z[i] - mx); den += e; if (i >= 1 && i <= l) num += e; }
            lbc[q] = num / den; }
        else if (j < 32) gbc[q] = F.in[I_GGB][l * 128 + h * 32 + j]; }
    if (!which) { const float* gu = F.in[I_GGU] + (size_t)l * 16 * 128; for (int i = tid; i < 16 * 32; i += 512) Wl[i] = gu[(i >> 5) * 128 + h * 32 + (i & 31)]; }
    float s[8];
#pragma unroll
    for (int i = 0; i < 8; ++i) s[i] = 0.f;
    __syncthreads();
    for (int tile = 0; tile < T / TT; ++tile) {
        const int t0 = tile * TT; const size_t m0 = (size_t)b * T + t0;
        if (!which) {
            for (int e = tid; e < TT * 16; e += 512) { const int tk = e >> 4, c = e & 15; U[e] = bf2f(proj[(m0 + tk) * NINP + C_GLA + 512 + c]); }
            __syncthreads();
        }
#pragma unroll
        for (int q = 0; q < 4; ++q) { const int j = jb + 16 * q; const bf16* pr = proj + (m0 + tok) * NINP;
            if (which) { const float qv = bf2f(pr[C_HGRN + h * 64 + j]), fl = bf2f(pr[C_HGRN + 256 + h * 64 + j]), iv = bf2f(pr[C_HGRN + 512 + h * 64 + j]), gv = bf2f(pr[C_HGRN + 768 + h * 64 + j]);
                const float f = lbc[q] + (1.f - lbc[q]) * sigmoidf_(fl);
                Vw[tok * 64 + j] = f; Vk[tok * 64 + j] = 1.f - f; Vq[tok * 64 + j] = qv; Vv[tok * 64 + j] = iv; Gg[tok * 64 + j] = gv * sigmoidf_(gv); }
            else { const float vv = bf2f(pr[C_GLA + 256 + h * 64 + j]), gv = bf2f(pr[C_GLA + 528 + h * 64 + j]);
                Vv[tok * 64 + j] = vv; Gg[tok * 64 + j] = gv * sigmoidf_(gv);
                if (j < 32) { const float qv = bf2f(pr[C_GLA + h * 32 + j]), kv = bf2f(pr[C_GLA + 128 + h * 32 + j]); float z = gbc[q];
#pragma unroll 4
                    for (int i = 0; i < 16; ++i) z += U[tok * 16 + i] * Wl[i * 32 + j];
                    const float la = (fminf(z, 0.f) - log1pf(__expf(-fabsf(z)))) * (1.f / 16.f);
                    Vw[tok * 64 + j] = __expf(la); Vk[tok * 64 + j] = kv; Vq[tok * 64 + j] = qv * 0.17677669529663687f; }
                else { Vw[tok * 64 + j] = 0.f; Vk[tok * 64 + j] = 0.f; Vq[tok * 64 + j] = 0.f; } } }
        __syncthreads();
        recur_tile<false>(s, lds, tid >> 3, tid & 7, TT);
        __syncthreads();
        { float y[4]; float sq = 0.f;
#pragma unroll
          for (int q = 0; q < 4; ++q) { y[q] = Yo[tok * 64 + jb + 16 * q]; sq += y[q] * y[q]; }
          const float rs = 1.f / sqrtf(red16(sq) * (1.f / 64.f) + NORM_EPS);
#pragma unroll
          for (int q = 0; q < 4; ++q) { const int j = jb + 16 * q; Y[(m0 + tok) * D + (which ? 768 : 256) + h * 64 + j] = (bf16)f2bf(y[q] * rs * nw[q] * Gg[tok * 64 + j]); } }
        __syncthreads();
    }
}

__device__ __forceinline__ void lru_unit(Frame& F, int l, int b, int hb) {
    LAS unsigned char* lds = F.lds; const int tid = F.tid;
    LAS float* Xb = (LAS float*)(lds + MX_U);
    LAS float* Xc = (LAS float*)(lds + MX_VW);
    LAS float* Av = (LAS float*)(lds + MX_VA); LAS float* Bv = (LAS float*)(lds + MX_VB); LAS float* Hv = (LAS float*)(lds + MX_YO);
    LAS float* Wa = (LAS float*)(lds + MX_W); LAS float* Wx = Wa + 64 * 64;
    const float* wa = F.in[I_LWA] + ((size_t)l * 4 + hb) * 4096; const float* wx = F.in[I_LWX] + ((size_t)l * 4 + hb) * 4096;
    for (int i = tid; i < 4096; i += 512) { Wa[i] = wa[i]; Wx[i] = wx[i]; }
    const bf16* proj = (const bf16*)(F.ws + WS_PROJ); bf16* Y = (bf16*)(F.ws + WS_Y);
    const int tok = tid >> 4, jb = tid & 15;
    float cw[4][4], cb[4], ba[4], bx[4], spl[4];
#pragma unroll
    for (int q = 0; q < 4; ++q) { const int c = hb * 64 + jb + 16 * q;
#pragma unroll
        for (int jj = 0; jj < 4; ++jj) cw[q][jj] = F.in[I_CW][(l * 4 + jj) * 256 + c];
        cb[q] = F.in[I_CB][l * 256 + c]; ba[q] = F.in[I_LBA][l * 256 + c]; bx[q] = F.in[I_LBX][l * 256 + c]; spl[q] = softplusf_(-F.in[I_LAM][l * 256 + c]); }
    float hstate = 0.f;
    __syncthreads();
    for (int tile = 0; tile < T / TT; ++tile) {
        const int t0 = tile * TT; const size_t m0 = (size_t)b * T + t0;
        for (int e = tid; e < 35 * 64; e += 512) { const int r = e >> 6, j = e & 63; const int t = t0 - 3 + r; Xb[e] = (t >= 0) ? bf2f(proj[((size_t)b * T + t) * NINP + C_LRU + hb * 64 + j]) : 0.f; }
        __syncthreads();
#pragma unroll
        for (int q = 0; q < 4; ++q) { const int j = jb + 16 * q; float xc = cb[q];
#pragma unroll
            for (int jj = 0; jj < 4; ++jj) xc += cw[q][jj] * Xb[(tok + jj) * 64 + j];
            Xc[tok * 64 + j] = xc; }
        __syncthreads();
        float rav[4], ixv[4];
#pragma unroll
        for (int q = 0; q < 4; ++q) { rav[q] = ba[q]; ixv[q] = bx[q]; }
#pragma unroll 2
        for (int i = 0; i < 64; ++i) { const float x = Xc[tok * 64 + i];
#pragma unroll
            for (int q = 0; q < 4; ++q) { rav[q] += x * Wa[i * 64 + jb + 16 * q]; ixv[q] += x * Wx[i * 64 + jb + 16 * q]; } }
#pragma unroll
        for (int q = 0; q < 4; ++q) { const int j = jb + 16 * q;
            const float r = sigmoidf_(rav[q]), ig = sigmoidf_(ixv[q]); const float la = -8.f * r * spl[q]; const float a = __expf(la);
            const float mult = sqrtf(fmaxf(1.f - __expf(2.f * la), 0.f));
            Av[tok * 64 + j] = a; Bv[tok * 64 + j] = mult * ig * Xc[tok * 64 + j]; }
        __syncthreads();
        if (tid < 64) { for (int st = 0; st < TT; ++st) { hstate = Av[st * 64 + tid] * hstate + Bv[st * 64 + tid]; Hv[st * 64 + tid] = hstate; } }
        __syncthreads();
#pragma unroll
        for (int q = 0; q < 4; ++q) { const int j = jb + 16 * q; const float gt = bf2f(proj[(m0 + tok) * NINP + C_LRU + 256 + hb * 64 + j]);
            const float ge = 0.5f * gt * (1.f + tanhf(0.7978845608028654f * (gt + 0.044715f * gt * gt * gt)));
            Y[(m0 + tok) * D + 512 + hb * 64 + j] = (bf16)f2bf(Hv[tok * 64 + j] * ge); }
        __syncthreads();
    }
}

__device__ __forceinline__ void mixer_phase_seq(Frame& F, int l) {
    for (int u = F.vcu; u < 128; u += F.G) {
        const int kind = u >> 5, b = (u & 31) >> 2, h = u & 3;
        if (kind == 0) rwkv_unit(F, l, b, h);
        else if (kind == 1) gla_unit(F, l, b, h, 0);
        else if (kind == 2) gla_unit(F, l, b, h, 1);
        else lru_unit(F, l, b, h);
    }
}

constexpr int PH_PER_LAYER = 7, N_PHASES = 1 + L * PH_PER_LAYER;
__global__ void __launch_bounds__(NWAVES * 64, 2) skel_fwd(Args args) {
    extern __shared__ __attribute__((aligned(16))) unsigned char lds[];
    Frame F;
    F.lds = (LAS unsigned char*)lds;
    F.MISC = (volatile LAS unsigned*)(F.lds + LDSCTL_OFF);
    F.tid = threadIdx.x; F.lane = F.tid & 63; F.wave = __builtin_amdgcn_readfirstlane(F.tid >> 6);
    F.G = gridDim.x; { const int bx = blockIdx.x; F.vcu = (F.G % 8 == 0) ? (bx % 8) * (F.G / 8) + bx / 8 : bx; }
    F.in = args.in; F.out = args.out; F.ws = args.ws;
    F.ctl = (gu32*)(args.ws + WS_CTL);
    for (int u = F.tid; u < (LDS_BYTES - LDSCTL_OFF) / 4; u += NWAVES * 64) ((LAS unsigned*)(F.lds + LDSCTL_OFF))[u] = 0u;
    __syncthreads();
#if MK_ONE_LAUNCH
    XcdBarrier bar = xcd_barrier_post((unsigned*)(F.ctl + CW_BAR), F.MISC + 8);
#define GRID_BAR() xcd_barrier(bar)
#else
#define GRID_BAR() do { } while (0)
#endif
    const int lo = args.ph_lo, hi = args.ph_hi;
    for (int ph = lo; ph < hi; ++ph) {
        { unsigned char* w_ = F.ws; asm volatile("" : "+s"(w_)); F.ws = w_; float* o_ = F.out; asm volatile("" : "+s"(o_)); F.out = o_; int t_ = threadIdx.x; asm volatile("" : "+v"(t_)); F.tid = t_; F.lane = t_ & 63; F.wave = __builtin_amdgcn_readfirstlane(t_ >> 6); }
        if (ph == 0) { p0_prologue(F); }
        else {
            const int l = (ph - 1) / PH_PER_LAYER, sub = (ph - 1) % PH_PER_LAYER;
            const float* xold = (l == 0) ? F.in[I_X] : F.out;
            if (sub == 0) {
                pg8::Gemm g{(const pg8::bf16_t*)(F.ws + WS_XN), (const pg8::bf16_t*)(F.ws + WS_WIN + l * SZ_WIN), M, NINP, D}; pg8::StaticOrder S; S.init(M, NINP, F.G, (int)blockIdx.x);
                pg8::EpiBf16<0> E{(pg8::bf16_t*)(F.ws + WS_PROJ), NINP, nullptr, 0, 0, 1.f};
                pg8::gemm_phase<pg8::EpiBf16<0>, pg8::StaticOrder, true, true>(F.lds + RING_OFF, g, S, E);
            } else if (sub == 1) { mixer_phase_seq(F, l);
            } else if (sub == 2) {
                pg8::Gemm g{(const pg8::bf16_t*)(F.ws + WS_Y), (const pg8::bf16_t*)(F.ws + WS_WOUT + l * SZ_WOUT), M, D, D}; pg8::StaticOrder S; S.init(M, D, F.G, (int)blockIdx.x);
                pg8::EpiF32 E{(float*)(F.ws + WS_TMP), D};
                pg8::gemm_phase<pg8::EpiF32, pg8::StaticOrder, true, true>(F.lds + RING_OFF, g, S, E);
            } else if (sub == 3) { norm_phase(F, xold, F.in[I_NMPOST] + l * D, F.in[I_NFPRE] + l * D);
            } else if (sub == 4) {
                pg8::Gemm g{(const pg8::bf16_t*)(F.ws + WS_XN), (const pg8::bf16_t*)(F.ws + WS_WGU + l * SZ_WGU), M, NGU, D}; pg8::StaticOrder S; S.init(M, NGU, F.G, (int)blockIdx.x);
                pg8::EpiSwiglu E{(pg8::bf16_t*)(F.ws + WS_ACT), FF};
                pg8::gemm_phase<pg8::EpiSwiglu, pg8::StaticOrder, true, true>(F.lds + RING_OFF, g, S, E);
            } else if (sub == 5) {
                pg8::Gemm g{(const pg8::bf16_t*)(F.ws + WS_ACT), (const pg8::bf16_t*)(F.ws + WS_WDN + l * SZ_WDN), M, D, FF}; pg8::StaticOrder S; S.init(M, D, F.G, (int)blockIdx.x);
                pg8::EpiF32 E{(float*)(F.ws + WS_TMP), D};
                pg8::gemm_phase<pg8::EpiF32, pg8::StaticOrder, true, true>(F.lds + RING_OFF, g, S, E);
            } else { norm_phase(F, F.out, F.in[I_NFPOST] + l * D, (l + 1 < L) ? F.in[I_NMPRE] + (l + 1) * D : nullptr); }
        }
        if (ph + 1 < hi) GRID_BAR();
    }
}

extern "C" void kernel_launch(void* const* d_in, const int* in_sizes, int n_in, void* d_out, int out_size, void* d_ws, size_t ws_size, hipStream_t stream) {
    static int grid = 0;
    if (grid == 0) {
        if (n_in != 32 || in_sizes[0] != M * D || out_size != M * D || ws_size < WS_END) { fprintf(stderr, "kernel_launch: unexpected shapes: n_in %d in0 %d out %d ws %zu (need %zu)\n", n_in, n_in > 0 ? in_sizes[0] : -1, out_size, ws_size, (size_t)WS_END); grid = -1; return; }
        int dev = 0, cus = 0, per_cu = 0;
        if (hipGetDevice(&dev) != hipSuccess || hipDeviceGetAttribute(&cus, hipDeviceAttributeMultiprocessorCount, dev) != hipSuccess) { grid = -1; return; }
        if (hipFuncSetAttribute((const void*)skel_fwd, hipFuncAttributeMaxDynamicSharedMemorySize, LDS_BYTES) != hipSuccess) { fprintf(stderr, "kernel_launch: hipFuncSetAttribute failed\n"); grid = -1; return; }
        if (hipOccupancyMaxActiveBlocksPerMultiprocessor(&per_cu, (const void*)skel_fwd, NWAVES * 64, LDS_BYTES) != hipSuccess || per_cu < 1) { fprintf(stderr, "kernel_launch: occupancy query says %d\n", per_cu); }
        (void)hipGetLastError();
        grid = cus;
    }
    if (grid < 0) return;
    if (hipMemsetAsync((char*)d_ws + WS_CTL, 0, CTL_ZERO_BYTES, stream) != hipSuccess) return;
    Args a{};
    for (int i = 0; i < 32; ++i) a.in[i] = (const float*)d_in[i];
    a.out = (float*)d_out; a.ws = (unsigned char*)d_ws;
#if MK_ONE_LAUNCH
    a.ph_lo = 0; a.ph_hi = N_PHASES;
    void* kargs[] = {&a};
    hipError_t e = hipLaunchCooperativeKernel((const void*)skel_fwd, dim3(grid), dim3(NWAVES * 64), kargs, LDS_BYTES, stream);
    if (e != hipSuccess) fprintf(stderr, "kernel_launch: cooperative launch failed: %s\n", hipGetErrorString(e));
#else
    for (int ph = 0; ph < N_PHASES; ++ph) { a.ph_lo = ph; a.ph_hi = ph + 1; hipLaunchKernelGGL(skel_fwd, dim3(grid), dim3(NWAVES * 64), LDS_BYTES, stream, a); }
#endif
}
```
